# Optimizing an MI355X kernel written in HIP

```python
import math
import jax, jax.numpy as jnp
from jax import lax
import numpy as np

D_MODEL = 1024
BATCH = 4
SEQ = 8192
DEPTH = 1

MEM_LEN = 256
MIX_WIDTH = D_MODEL
ATT_WIDTH = MIX_WIDTH // 2
CONV_WIDTH = MIX_WIDTH - ATT_WIDTH
ATT_HEADS = 4
ATT_HEAD_DIM = ATT_WIDTH // ATT_HEADS
QK_DIM = ATT_HEAD_DIM // 2
QK_TOTAL = ATT_HEADS * 2 * QK_DIM
CONV_GROUPS = 4
CONV_GROUP_DIM = CONV_WIDTH // CONV_GROUPS
CONV_KERNEL = 31
IN_COLS = 2 * QK_TOTAL + ATT_WIDTH + 2 * CONV_WIDTH
MEM_HEADS = 4
MEM_HEAD_DIM = D_MODEL // MEM_HEADS
D_FF = -(-8 * D_MODEL // (3 * 256)) * 256
Q_BLOCK = 128
LN_EPS = 1e-5
DEEPNORM_ALPHA = (2 * DEPTH) ** 0.25
DEEPNORM_BETA = (8 * DEPTH) ** -0.25

kernel_name = "hybrid_diffattn_conformer_deepnorm"


def layer_norm(x, g, b):
    xf = x.astype(jnp.float32)
    mu = xf.mean(-1, keepdims=True)
    var = jnp.square(xf - mu).mean(-1, keepdims=True)
    return ((xf - mu) * lax.rsqrt(var + LN_EPS) * g.astype(jnp.float32) + b.astype(jnp.float32)).astype(x.dtype)


def rms_norm(x, g):
    xf = x.astype(jnp.float32)
    return xf * lax.rsqrt(jnp.mean(xf * xf, -1, keepdims=True) + LN_EPS) * g.astype(jnp.float32)


def alibi_slopes(n_heads):
    return jnp.exp2(-8.0 * jnp.arange(1, n_heads + 1, dtype=jnp.float32) / n_heads)


def diff_attention(q, k, v, lam, slopes):
    b, s, h, _, dk = q.shape
    nb = s // Q_BLOCK
    qb = q.reshape(b, nb, Q_BLOCK, h, 2, dk).transpose(1, 0, 2, 3, 4, 5)
    vf = v.astype(jnp.float32)
    k_pos = jnp.arange(s)
    scale = dk ** -0.5

    def block(args):
        q_blk, i = args
        q_pos = i * Q_BLOCK + jnp.arange(Q_BLOCK)
        dist = q_pos[:, None] - k_pos[None, :]
        bias = -slopes[:, None, None] * dist.astype(jnp.float32)
        logits = jnp.einsum('bqhcd,bkhcd->bhcqk', q_blk, k,
                            preferred_element_type=jnp.float32) * scale + bias[None, :, None]
        logits = jnp.where(dist[None, None, None] >= 0, logits, -jnp.inf)
        p = jax.nn.softmax(logits, axis=-1)
        a = p[:, :, 0] - lam * p[:, :, 1]
        return jnp.einsum('bhqk,bkhe->bqhe', a, vf)

    out = lax.map(block, (qb, jnp.arange(nb)))
    return out.transpose(1, 0, 2, 3, 4).reshape(b, s, h, -1)


def causal_depthwise_conv(u, w, bias):
    c = u.shape[-1]
    out = lax.conv_general_dilated(u, w[:, None, :].astype(u.dtype), window_strides=(1,),
                                   padding=((w.shape[0] - 1, 0),),
                                   dimension_numbers=('NWC', 'WIO', 'NWC'),
                                   feature_group_count=c)
    return out + bias


def setup_inputs(seed: int = 0) -> dict:
    key = jax.random.key(seed)
    ks = iter(jax.random.split(key, 40))

    def nrm(shape, scale):
        return jax.random.normal(next(ks), shape, jnp.float32) * scale

    def gain(shape):
        return 1.0 + nrm(shape, 0.02)

    L = DEPTH
    d = {}
    d["x"] = nrm((BATCH, SEQ, D_MODEL), 1.0)
    d["mem"] = nrm((BATCH, MEM_LEN, D_MODEL), 1.0)
    d["in_norm_g"] = gain((D_MODEL,))
    d["in_norm_b"] = nrm((D_MODEL,), 0.02)
    d["w_in"] = nrm((L, D_MODEL, IN_COLS), D_MODEL ** -0.5)
    d["lambda_q1"] = nrm((L, QK_DIM), 0.1)
    d["lambda_k1"] = nrm((L, QK_DIM), 0.1)
    d["lambda_q2"] = nrm((L, QK_DIM), 0.1)
    d["lambda_k2"] = nrm((L, QK_DIM), 0.1)
    d["subln_g"] = gain((L, ATT_HEAD_DIM))
    d["conv_w"] = nrm((L, CONV_KERNEL, CONV_WIDTH), CONV_KERNEL ** -0.5)
    d["conv_b"] = nrm((L, CONV_WIDTH), 0.02)
    d["conv_norm_g"] = gain((L, CONV_WIDTH))
    d["conv_norm_b"] = nrm((L, CONV_WIDTH), 0.02)
    d["w_pw"] = nrm((L, CONV_WIDTH, CONV_WIDTH), CONV_WIDTH ** -0.5)
    d["b_pw"] = nrm((L, CONV_WIDTH), 0.02)
    d["w_o"] = nrm((L, MIX_WIDTH, D_MODEL), DEEPNORM_BETA * MIX_WIDTH ** -0.5)
    d["ln1_g"] = gain((L, D_MODEL))
    d["ln1_b"] = nrm((L, D_MODEL), 0.02)
    d["w_q_mem"] = nrm((L, D_MODEL, D_MODEL), D_MODEL ** -0.5)
    d["w_kv_mem"] = nrm((L, D_MODEL, 2 * D_MODEL), D_MODEL ** -0.5)
    d["w_o_mem"] = nrm((L, D_MODEL, D_MODEL), DEEPNORM_BETA * D_MODEL ** -0.5)
    d["ln2_g"] = gain((L, D_MODEL))
    d["ln2_b"] = nrm((L, D_MODEL), 0.02)
    d["w_gate"] = nrm((L, D_MODEL, D_FF), D_MODEL ** -0.5)
    d["w_up"] = nrm((L, D_MODEL, D_FF), D_MODEL ** -0.5)
    d["w_down"] = nrm((L, D_FF, D_MODEL), DEEPNORM_BETA * D_FF ** -0.5)
    d["ln3_g"] = gain((L, D_MODEL))
    d["ln3_b"] = nrm((L, D_MODEL), 0.02)
    return d


def reference(x, mem, in_norm_g, in_norm_b, w_in, lambda_q1, lambda_k1, lambda_q2, lambda_k2,
              subln_g, conv_w, conv_b, conv_norm_g, conv_norm_b, w_pw, b_pw, w_o, ln1_g, ln1_b,
              w_q_mem, w_kv_mem, w_o_mem, ln2_g, ln2_b, w_gate, w_up, w_down, ln3_g, ln3_b):
    bsz, s, _ = x.shape
    slopes = alibi_slopes(ATT_HEADS)
    x = layer_norm(x, in_norm_g, in_norm_b)
    for l in range(DEPTH):
        lam_init = 0.8 - 0.6 * math.exp(-0.3 * l)
        proj = x @ w_in[l]
        q, k, v, c_val, c_gate = jnp.split(
            proj, [QK_TOTAL, 2 * QK_TOTAL, 2 * QK_TOTAL + ATT_WIDTH,
                   2 * QK_TOTAL + ATT_WIDTH + CONV_WIDTH], axis=-1)
        q = q.reshape(bsz, s, ATT_HEADS, 2, QK_DIM)
        k = k.reshape(bsz, s, ATT_HEADS, 2, QK_DIM)
        v = v.reshape(bsz, s, ATT_HEADS, ATT_HEAD_DIM)
        lam = (jnp.exp(jnp.sum(lambda_q1[l] * lambda_k1[l]).astype(jnp.float32))
               - jnp.exp(jnp.sum(lambda_q2[l] * lambda_k2[l]).astype(jnp.float32)) + lam_init)
        att = diff_attention(q, k, v, lam, slopes)
        att = rms_norm(att, subln_g[l]) * (1.0 - lam_init)
        att = att.reshape(bsz, s, ATT_WIDTH).astype(x.dtype)
        glu = c_val * jax.nn.sigmoid(c_gate)
        c = causal_depthwise_conv(glu, conv_w[l], conv_b[l])
        c = layer_norm(c.reshape(bsz, s, CONV_GROUPS, CONV_GROUP_DIM),
                       conv_norm_g[l].reshape(CONV_GROUPS, CONV_GROUP_DIM),
                       conv_norm_b[l].reshape(CONV_GROUPS, CONV_GROUP_DIM)).reshape(bsz, s, CONV_WIDTH)
        c = jax.nn.silu(c) @ w_pw[l] + b_pw[l]
        mix = jnp.concatenate([att, c], axis=-1) @ w_o[l]
        x = layer_norm(DEEPNORM_ALPHA * x + mix, ln1_g[l], ln1_b[l])
        qc = (x @ w_q_mem[l]).reshape(bsz, s, MEM_HEADS, MEM_HEAD_DIM)
        kc, vc = jnp.split(mem @ w_kv_mem[l], 2, axis=-1)
        kc = kc.reshape(bsz, -1, MEM_HEADS, MEM_HEAD_DIM)
        vc = vc.reshape(bsz, -1, MEM_HEADS, MEM_HEAD_DIM)
        logits = jnp.einsum('bshd,bmhd->bhsm', qc, kc,
                            preferred_element_type=jnp.float32) * (MEM_HEAD_DIM ** -0.5)
        p = jax.nn.softmax(logits, axis=-1)
        ca = jnp.einsum('bhsm,bmhd->bshd', p, vc.astype(jnp.float32)).reshape(bsz, s, D_MODEL).astype(x.dtype)
        x = layer_norm(DEEPNORM_ALPHA * x + ca @ w_o_mem[l], ln2_g[l], ln2_b[l])
        hdn = jax.nn.silu(x @ w_gate[l]) * (x @ w_up[l])
        x = layer_norm(DEEPNORM_ALPHA * x + hdn @ w_down[l], ln3_g[l], ln3_b[l])
    return x
```

```cpp
#include <hip/hip_runtime.h>
#include <cstdint>
#include <cstdio>

typedef unsigned short bf16;
typedef short bf16x8 __attribute__((ext_vector_type(8)));
typedef float f32x16 __attribute__((ext_vector_type(16)));
typedef float f32x4 __attribute__((ext_vector_type(4)));
typedef unsigned v4u __attribute__((ext_vector_type(4)));
#define LAS __attribute__((address_space(3)))
#define DI __device__ __forceinline__

constexpr int BATCH = 4, SEQ = 8192, D = 1024, M = BATCH * SEQ, MEMLEN = 256, MROWS = BATCH * MEMLEN;
constexpr int NIN = 2560, DFF = 2816, NGU = 2 * DFF;
constexpr float LN_EPS = 1e-5f;
constexpr float ALPHA = 1.189207115002721f;
constexpr float LOG2E = 1.4426950408889634f;
constexpr float C2Q = 0.125f * LOG2E;
constexpr float C2C = 0.0625f * LOG2E;
constexpr float LAM_INIT = 0.2f;

constexpr size_t MiB = 1u << 20;
constexpr size_t WS_CTL = 0, CTL_ZERO_BYTES = 1 * MiB;
constexpr size_t WS_STATS = 1 * MiB;
constexpr size_t WS_XCH = 2 * MiB;
constexpr size_t WS_WIN = 8 * MiB;
constexpr size_t WS_WPW = 13 * MiB;
constexpr size_t WS_WO = 14 * MiB;
constexpr size_t WS_WQ = 16 * MiB;
constexpr size_t WS_WKV = 18 * MiB;
constexpr size_t WS_WOM = 22 * MiB;
constexpr size_t WS_WGU = 24 * MiB;
constexpr size_t WS_WDN = 35 * MiB;
constexpr size_t WS_MEMB = 41 * MiB;
constexpr size_t WS_KC = 43 * MiB;
constexpr size_t WS_VCT = 45 * MiB;
constexpr size_t WS_A = 48 * MiB;
constexpr size_t WS_B = 112 * MiB;
constexpr size_t WS_Q = WS_B, WS_K = WS_B + 32 * MiB, WS_V = WS_B + 64 * MiB, WS_GLU = WS_B + 96 * MiB;
constexpr size_t WS_XB = WS_B;
constexpr size_t WS_P = WS_B + 64 * MiB;
constexpr size_t WS_O12 = 240 * MiB;
constexpr size_t WS_SC = 368 * MiB;
constexpr size_t WS_HDN = 176 * MiB;
constexpr size_t WS_TEMP = 352 * MiB;
constexpr size_t WS_END = 480 * MiB;

DI unsigned f2bf(float f) { unsigned u = __builtin_bit_cast(unsigned, f); return (u + 0x7fffu + ((u >> 16) & 1u)) >> 16; }
DI unsigned pk2(float lo, float hi) { return f2bf(lo) | (f2bf(hi) << 16); }
DI float bf2f(unsigned short b) { return __builtin_bit_cast(float, (unsigned)b << 16); }
DI float wave_sum(float v) {
#pragma unroll
    for (int o = 1; o < 64; o <<= 1) v += __shfl_xor(v, o);
    return v;
}
DI float wave_max(float v) {
#pragma unroll
    for (int o = 1; o < 64; o <<= 1) v = fmaxf(v, __shfl_xor(v, o));
    return v;
}
DI int crow(int r, int hi) { return (r & 3) + 8 * (r >> 2) + 4 * hi; }

struct P0Args {
    const float* x; const float* mem; const float* g; const float* b;
    const float* w[9];
    unsigned char* ws;
};
DI void p0_transpose_item(const float* W, int K, int N, bf16* WT, int drow0, LAS float* scr, int kb, int nb, int lane) {
    const int k0 = 64 * kb, n0 = 32 * nb;
#pragma unroll 8
    for (int i = 0; i < 32; ++i) { const int kk = 2 * i + (lane >> 5); scr[kk * 33 + (lane & 31)] = W[(size_t)(k0 + kk) * N + n0 + (lane & 31)]; }
    asm volatile("s_waitcnt lgkmcnt(0)" ::: "memory");
    const int c = lane & 7;
#pragma unroll
    for (int j = 0; j < 4; ++j) { const int n = (lane >> 3) + 8 * j; const LAS float* s = scr + (8 * c) * 33 + n;
        v4u o; o.x = pk2(s[0 * 33], s[1 * 33]); o.y = pk2(s[2 * 33], s[3 * 33]); o.z = pk2(s[4 * 33], s[5 * 33]); o.w = pk2(s[6 * 33], s[7 * 33]);
        *(v4u*)(WT + (size_t)(drow0 + n) * K + k0 + 8 * c) = o; }
    asm volatile("s_waitcnt lgkmcnt(0)" ::: "memory");
}
DI int gl_map(int c) { return (c >> 7) * 256 + (c & 127); }
DI void p0_body(const P0Args& a, LAS unsigned char* lds, int gw, int NGW, int wave, int lane) {
    LAS float* scr = (LAS float*)(lds + wave * 8704);
    unsigned char* ws = a.ws;
    for (int it = gw; it < 8192; it += NGW) {
        int r = it;
        if (r < 1280) { const int kb = r / 80, nb = r % 80, n0 = nb * 32;
            const int dr = n0 < 1536 ? n0 : (n0 < 2048 ? 1536 + gl_map(n0 - 1536) : 1536 + gl_map(n0 - 2048) + 128);
            p0_transpose_item(a.w[0], 1024, 2560, (bf16*)(ws + WS_WIN), dr, scr, kb, nb, lane); continue; } r -= 1280;
        if (r < 128) { p0_transpose_item(a.w[1], 512, 512, (bf16*)(ws + WS_WPW), (r % 16) * 32, scr, r / 16, r % 16, lane); continue; } r -= 128;
        if (r < 512) { p0_transpose_item(a.w[2], 1024, 1024, (bf16*)(ws + WS_WO), (r % 32) * 32, scr, r / 32, r % 32, lane); continue; } r -= 512;
        if (r < 512) { p0_transpose_item(a.w[3], 1024, 1024, (bf16*)(ws + WS_WQ), (r % 32) * 32, scr, r / 32, r % 32, lane); continue; } r -= 512;
        if (r < 1024) { p0_transpose_item(a.w[4], 1024, 2048, (bf16*)(ws + WS_WKV), (r % 64) * 32, scr, r / 64, r % 64, lane); continue; } r -= 1024;
        if (r < 512) { p0_transpose_item(a.w[5], 1024, 1024, (bf16*)(ws + WS_WOM), (r % 32) * 32, scr, r / 32, r % 32, lane); continue; } r -= 512;
        if (r < 1408) { p0_transpose_item(a.w[6], 1024, 2816, (bf16*)(ws + WS_WGU), gl_map((r % 88) * 32), scr, r / 88, r % 88, lane); continue; } r -= 1408;
        if (r < 1408) { p0_transpose_item(a.w[7], 1024, 2816, (bf16*)(ws + WS_WGU), gl_map((r % 88) * 32) + 128, scr, r / 88, r % 88, lane); continue; } r -= 1408;
        p0_transpose_item(a.w[8], 2816, 1024, (bf16*)(ws + WS_WDN), (r % 32) * 32, scr, r / 32, r % 32, lane);
    }
    f32x4 gg[4], bb[4];
#pragma unroll
    for (int j = 0; j < 4; ++j) { gg[j] = *((const f32x4*)a.g + lane + 64 * j); bb[j] = *((const f32x4*)a.b + lane + 64 * j); }
    for (int m = gw; m < M + MROWS; m += NGW) {
        if (m < M) {
            const f32x4* xr = (const f32x4*)(a.x + (size_t)m * D) + lane;
            f32x4 v[4]; float s = 0.f;
#pragma unroll
            for (int j = 0; j < 4; ++j) { v[j] = xr[64 * j]; s += (v[j].x + v[j].y) + (v[j].z + v[j].w); }
            const float mean = wave_sum(s) * (1.f / D); float s2 = 0.f;
#pragma unroll
            for (int j = 0; j < 4; ++j) { v[j] = v[j] - mean; s2 += (v[j].x * v[j].x + v[j].y * v[j].y) + (v[j].z * v[j].z + v[j].w * v[j].w); }
            const float rstd = 1.f / sqrtf(wave_sum(s2) * (1.f / D) + LN_EPS);
            unsigned long long* o8 = (unsigned long long*)((bf16*)(ws + WS_A) + (size_t)m * D) + lane;
#pragma unroll
            for (int j = 0; j < 4; ++j) { const f32x4 y = v[j] * rstd * gg[j] + bb[j];
                o8[64 * j] = (unsigned long long)pk2(y.x, y.y) | ((unsigned long long)pk2(y.z, y.w) << 32); }
            if (lane == 0) { float2 st; st.x = mean; st.y = rstd; ((float2*)(ws + WS_STATS))[m] = st; }
        } else {
            const int r = m - M;
            const f32x4* xr = (const f32x4*)(a.mem + (size_t)r * D) + lane;
            unsigned long long* o8 = (unsigned long long*)((bf16*)(ws + WS_MEMB) + (size_t)r * D) + lane;
#pragma unroll
            for (int j = 0; j < 4; ++j) { const f32x4 y = xr[64 * j]; o8[64 * j] = (unsigned long long)pk2(y.x, y.y) | ((unsigned long long)pk2(y.z, y.w) << 32); }
        }
    }
}
__global__ __launch_bounds__(512) void p0_kernel(P0Args a) {
    __shared__ __attribute__((aligned(16))) unsigned char lds[8 * 8704];
    const int wave = threadIdx.x >> 6, lane = threadIdx.x & 63;
    p0_body(a, (LAS unsigned char*)lds, blockIdx.x * 8 + wave, gridDim.x * 8, wave, lane);
}

template <class Epi, bool DUAL>
__global__ __launch_bounds__(256) void ngemm(const bf16* A, long lda, const bf16* Bt, long ldb, int K, long aZb, long aZh, long bZb, long bZh, Epi epi) {
    const int w = threadIdx.x >> 6, lane = threadIdx.x & 63, r32 = lane & 31, hi = lane >> 5;
    const int z = blockIdx.z, zb = z >> 2, zh = z & 3;
    const bf16* Ap = A + zb * aZb + zh * aZh + (long)(blockIdx.y * 32 + r32) * lda + hi * 8;
    const int col0 = blockIdx.x * 128 + w * 32, c = col0 + r32;
    const long brow = DUAL ? gl_map(c) : c;
    const bf16* Bp = Bt + zb * bZb + zh * bZh + brow * ldb + hi * 8;
    f32x16 acc0 = {}, acc1 = {};
    for (int k = 0; k < K; k += 16) {
        const bf16x8 av = *(const bf16x8*)(Ap + k), b0 = *(const bf16x8*)(Bp + k);
        acc0 = __builtin_amdgcn_mfma_f32_32x32x16_bf16(av, b0, acc0, 0, 0, 0);
        if (DUAL) { const bf16x8 b1 = *(const bf16x8*)(Bp + 128 * ldb + k); acc1 = __builtin_amdgcn_mfma_f32_32x32x16_bf16(av, b1, acc1, 0, 0, 0); }
    }
#pragma unroll
    for (int r = 0; r < 16; ++r) epi(z, blockIdx.y * 32 + crow(r, hi), c, acc0[r], acc1[r]);
}
DI float sigmoidf_(float x) { return 1.f / (1.f + __expf(-x)); }
struct EpiQKV { bf16 *Q, *K, *V; DI void operator()(int, int m, int n, float v, float) const {
    if (n < 512) Q[(size_t)m * 512 + n] = f2bf(v * C2Q); else if (n < 1024) K[(size_t)m * 512 + n - 512] = f2bf(v); else V[(size_t)m * 512 + n - 1024] = f2bf(v); } };
struct EpiGLU { bf16* G; DI void operator()(int, int m, int n, float v, float g) const { G[(size_t)m * 512 + n] = f2bf(v * sigmoidf_(g)); } };
struct EpiKV { bf16 *KC, *VCT; DI void operator()(int, int m, int n, float v, float) const {
    if (n < 1024) KC[(size_t)m * 1024 + n] = f2bf(v); else VCT[((size_t)(m >> 8) * 1024 + (n - 1024)) * 256 + (m & 255)] = f2bf(v); } };
struct EpiPW { bf16* CAT; const float* bias; DI void operator()(int, int m, int n, float v, float) const { CAT[(size_t)m * 1024 + 512 + n] = f2bf(v + bias[n]); } };
struct EpiF32 { float* T; DI void operator()(int, int m, int n, float v, float) const { T[(size_t)m * 1024 + n] = v; } };
struct EpiQC { bf16* QC; DI void operator()(int, int m, int n, float v, float) const { QC[(size_t)m * 1024 + n] = f2bf(v * C2C); } };
struct EpiS { float* T; DI void operator()(int z, int m, int n, float v, float) const { T[((size_t)(z >> 2) * SEQ + m) * 1024 + (z & 3) * 256 + n] = v; } };
struct EpiPV { bf16* CA; DI void operator()(int z, int m, int n, float v, float) const { CA[((size_t)(z >> 2) * SEQ + m) * 1024 + (z & 3) * 256 + n] = f2bf(v); } };
struct EpiSwi { bf16* H; DI void operator()(int, int m, int n, float g, float u) const { H[(size_t)m * DFF + n] = f2bf(g * sigmoidf_(g) * u); } };

__global__ __launch_bounds__(256) void nattn(const bf16* Q, const bf16* K, const bf16* V, float* O12) {
    const int lane = threadIdx.x & 63; const long wv = (long)blockIdx.x * 4 + (threadIdx.x >> 6);
    const int c = wv & 1, h = (wv >> 1) & 3; const long row = wv >> 3; const int b = row / SEQ, qpos = row % SEQ;
    const float sl2 = exp2f(-2.f * (h + 1)) * LOG2E;
    float q[64];
    { const bf16* qp = Q + row * 512 + h * 128 + c * 64;
#pragma unroll
      for (int d = 0; d < 64; ++d) q[d] = bf2f(qp[d]); }
    float m = -INFINITY, l = 0.f, o0 = 0.f, o1 = 0.f;
    const bf16* Kb = K + (long)b * SEQ * 512 + h * 128 + c * 64; const bf16* Vb = V + (long)b * SEQ * 512 + h * 128 + 2 * lane;
    for (int j0 = 0; j0 <= qpos; j0 += 64) {
        const int j = j0 + lane; float s = -INFINITY;
        if (j <= qpos) { const bf16x8* kp = (const bf16x8*)(Kb + (long)j * 512); float acc = 0.f;
#pragma unroll
            for (int i = 0; i < 8; ++i) { const bf16x8 kv = kp[i];
#pragma unroll
                for (int e = 0; e < 8; ++e) acc += q[i * 8 + e] * bf2f((unsigned short)kv[e]); }
            s = acc + sl2 * (float)(j - qpos); }
        const float tm = wave_max(s), mn = fmaxf(m, tm), corr = exp2f(m - mn), p = exp2f(s - mn);
        l = l * corr + wave_sum(p); o0 *= corr; o1 *= corr; m = mn;
        const int nk = min(64, qpos - j0 + 1);
        for (int jj = 0; jj < nk; ++jj) { const float pj = __shfl(p, jj); const unsigned vv = *(const unsigned*)(Vb + (long)(j0 + jj) * 512);
            o0 += pj * bf2f(vv & 0xffff); o1 += pj * bf2f(vv >> 16); }
    }
    const float inv = 1.f / l;
    float2 r; r.x = o0 * inv; r.y = o1 * inv;
    *(float2*)(O12 + ((row * 4 + h) * 2 + c) * 128 + 2 * lane) = r;
}
DI float compute_lam(const float* lq1, const float* lk1, const float* lq2, const float* lk2, int lane) {
    const float s1 = wave_sum(lq1[lane] * lk1[lane]), s2 = wave_sum(lq2[lane] * lk2[lane]);
    return expf(s1) - expf(s2) + LAM_INIT;
}
__global__ __launch_bounds__(256) void ncombine(const float* O12, const float* lq1, const float* lk1, const float* lq2, const float* lk2, const float* subg, bf16* CAT) {
    const int lane = threadIdx.x & 63; const long wv = (long)blockIdx.x * 4 + (threadIdx.x >> 6);
    const int h = wv & 3; const long row = wv >> 2;
    const float lam = compute_lam(lq1, lk1, lq2, lk2, lane);
    const float2 a = *(const float2*)(O12 + ((row * 4 + h) * 2 + 0) * 128 + 2 * lane), bb = *(const float2*)(O12 + ((row * 4 + h) * 2 + 1) * 128 + 2 * lane);
    const float d0 = a.x - lam * bb.x, d1 = a.y - lam * bb.y;
    const float ms = wave_sum(d0 * d0 + d1 * d1) * (1.f / 128.f), r = 1.f / sqrtf(ms + LN_EPS) * (1.f - LAM_INIT);
    *(unsigned*)(CAT + row * 1024 + h * 128 + 2 * lane) = pk2(d0 * r * subg[2 * lane], d1 * r * subg[2 * lane + 1]);
}
__global__ __launch_bounds__(256) void nconv(const bf16* GLU, const float* cw, const float* cb, const float* ng, const float* nb, bf16* SC) {
    const int lane = threadIdx.x & 63; const long wv = (long)blockIdx.x * 4 + (threadIdx.x >> 6);
    const int g = wv & 3; const long row = wv >> 2; const int t = row % SEQ; const int ch = g * 128 + 2 * lane;
    float a0 = cb[ch], a1 = cb[ch + 1];
    for (int j = 0; j < 31; ++j) { const int tt = t - 30 + j; if (tt < 0) continue;
        const unsigned vv = *(const unsigned*)(GLU + (row - 30 + j) * 512 + ch);
        a0 += bf2f(vv & 0xffff) * cw[j * 512 + ch]; a1 += bf2f(vv >> 16) * cw[j * 512 + ch + 1]; }
    const float mean = wave_sum(a0 + a1) * (1.f / 128.f); const float e0 = a0 - mean, e1 = a1 - mean;
    const float var = wave_sum(e0 * e0 + e1 * e1) * (1.f / 128.f), rstd = 1.f / sqrtf(var + LN_EPS);
    const float y0 = e0 * rstd * ng[ch] + nb[ch], y1 = e1 * rstd * ng[ch + 1] + nb[ch + 1];
    *(unsigned*)(SC + row * 512 + ch) = pk2(y0 * sigmoidf_(y0), y1 * sigmoidf_(y1));
}
template <int MODE, bool WRITE_B>
__global__ __launch_bounds__(256) void nln(const float* T, const float* x, const float2* stats, const float* gin, const float* bin, const float* g, const float* b, float* OUT, bf16* XB) {
    const int lane = threadIdx.x & 63; const long row = (long)blockIdx.x * 4 + (threadIdx.x >> 6);
    f32x4 v[4]; float s = 0.f;
#pragma unroll
    for (int j = 0; j < 4; ++j) { const int cidx = lane + 64 * j; f32x4 base;
        if (MODE == 0) { const float2 st = stats[row]; base = (((const f32x4*)(x + row * D))[cidx] - st.x) * st.y * ((const f32x4*)gin)[cidx] + ((const f32x4*)bin)[cidx]; }
        else base = ((const f32x4*)(OUT + row * D))[cidx];
        v[j] = base * ALPHA + ((const f32x4*)(T + row * D))[cidx]; s += (v[j].x + v[j].y) + (v[j].z + v[j].w); }
    const float mean = wave_sum(s) * (1.f / D); float s2 = 0.f;
#pragma unroll
    for (int j = 0; j < 4; ++j) { v[j] = v[j] - mean; s2 += (v[j].x * v[j].x + v[j].y * v[j].y) + (v[j].z * v[j].z + v[j].w * v[j].w); }
    const float rstd = 1.f / sqrtf(wave_sum(s2) * (1.f / D) + LN_EPS);
#pragma unroll
    for (int j = 0; j < 4; ++j) { const int cidx = lane + 64 * j; const f32x4 y = v[j] * rstd * ((const f32x4*)g)[cidx] + ((const f32x4*)b)[cidx];
        ((f32x4*)(OUT + row * D))[cidx] = y;
        if (WRITE_B) ((unsigned long long*)(XB + row * D))[cidx] = (unsigned long long)pk2(y.x, y.y) | ((unsigned long long)pk2(y.z, y.w) << 32); }
}
__global__ __launch_bounds__(256) void nxsoftmax(const float* T, bf16* P) {
    const int lane = threadIdx.x & 63; const long wv = (long)blockIdx.x * 4 + (threadIdx.x >> 6);
    const f32x4 s = ((const f32x4*)(T + wv * 256))[lane];
    const float mx = wave_max(fmaxf(fmaxf(s.x, s.y), fmaxf(s.z, s.w)));
    const float p0 = exp2f(s.x - mx), p1 = exp2f(s.y - mx), p2 = exp2f(s.z - mx), p3 = exp2f(s.w - mx);
    const float inv = 1.f / wave_sum((p0 + p1) + (p2 + p3));
    ((unsigned long long*)(P + wv * 256))[lane] = (unsigned long long)pk2(p0 * inv, p1 * inv) | ((unsigned long long)pk2(p2 * inv, p3 * inv) << 32);
}

extern "C" void kernel_launch(void* const* d_in, const int* in_sizes, int n_in, void* d_out, int out_size, void* d_ws, size_t ws_size, hipStream_t stream) {
    if (n_in != 29 || out_size != M * D || ws_size < WS_END) { fprintf(stderr, "kernel_launch: unexpected shapes (n_in %d out %d ws %zu)\n", n_in, out_size, ws_size); return; }
    const float* const* in = (const float* const*)d_in;
    unsigned char* ws = (unsigned char*)d_ws; float* out = (float*)d_out;
    bf16 *WIN = (bf16*)(ws + WS_WIN), *WPW = (bf16*)(ws + WS_WPW), *WO = (bf16*)(ws + WS_WO), *WQ = (bf16*)(ws + WS_WQ), *WKV = (bf16*)(ws + WS_WKV), *WOM = (bf16*)(ws + WS_WOM),
         *WGU = (bf16*)(ws + WS_WGU), *WDN = (bf16*)(ws + WS_WDN), *MEMB = (bf16*)(ws + WS_MEMB), *KC = (bf16*)(ws + WS_KC), *VCT = (bf16*)(ws + WS_VCT);
    bf16 *BA = (bf16*)(ws + WS_A), *Qb = (bf16*)(ws + WS_Q), *Kb = (bf16*)(ws + WS_K), *Vb = (bf16*)(ws + WS_V), *GLU = (bf16*)(ws + WS_GLU), *XB = (bf16*)(ws + WS_XB), *Pb = (bf16*)(ws + WS_P),
         *SC = (bf16*)(ws + WS_SC), *HDN = (bf16*)(ws + WS_HDN);
    float *O12 = (float*)(ws + WS_O12), *TEMP = (float*)(ws + WS_TEMP); const float2* STATS = (const float2*)(ws + WS_STATS);
    (void)hipMemsetAsync(ws + WS_CTL, 0, CTL_ZERO_BYTES, stream);
    P0Args pa{}; pa.x = in[0]; pa.mem = in[1]; pa.g = in[2]; pa.b = in[3];
    pa.w[0] = in[4]; pa.w[1] = in[14]; pa.w[2] = in[16]; pa.w[3] = in[19]; pa.w[4] = in[20]; pa.w[5] = in[21]; pa.w[6] = in[24]; pa.w[7] = in[25]; pa.w[8] = in[26]; pa.ws = ws;
    hipLaunchKernelGGL(p0_kernel, dim3(1024), dim3(512), 0, stream, pa);
    hipLaunchKernelGGL((ngemm<EpiQKV, false>), dim3(1536 / 128, M / 32, 1), dim3(256), 0, stream, BA, 1024L, WIN, 1024L, 1024, 0L, 0L, 0L, 0L, EpiQKV{Qb, Kb, Vb});
    hipLaunchKernelGGL((ngemm<EpiGLU, true>), dim3(512 / 128, M / 32, 1), dim3(256), 0, stream, BA, 1024L, WIN + 1536 * 1024, 1024L, 1024, 0L, 0L, 0L, 0L, EpiGLU{GLU});
    hipLaunchKernelGGL((ngemm<EpiKV, false>), dim3(2048 / 128, MROWS / 32, 1), dim3(256), 0, stream, MEMB, 1024L, WKV, 1024L, 1024, 0L, 0L, 0L, 0L, EpiKV{KC, VCT});
    hipLaunchKernelGGL(nattn, dim3(M * 8 / 4), dim3(256), 0, stream, Qb, Kb, Vb, O12);
    hipLaunchKernelGGL(nconv, dim3(M * 4 / 4), dim3(256), 0, stream, GLU, in[10], in[11], in[12], in[13], SC);
    hipLaunchKernelGGL(ncombine, dim3(M * 4 / 4), dim3(256), 0, stream, O12, in[5], in[6], in[7], in[8], in[9], BA);
    hipLaunchKernelGGL((ngemm<EpiPW, false>), dim3(512 / 128, M / 32, 1), dim3(256), 0, stream, SC, 512L, WPW, 512L, 512, 0L, 0L, 0L, 0L, EpiPW{BA, in[15]});
    hipLaunchKernelGGL((ngemm<EpiF32, false>), dim3(1024 / 128, M / 32, 1), dim3(256), 0, stream, BA, 1024L, WO, 1024L, 1024, 0L, 0L, 0L, 0L, EpiF32{TEMP});
    hipLaunchKernelGGL((nln<0, true>), dim3(M / 4), dim3(256), 0, stream, TEMP, in[0], STATS, in[2], in[3], in[17], in[18], out, XB);
    hipLaunchKernelGGL((ngemm<EpiQC, false>), dim3(1024 / 128, M / 32, 1), dim3(256), 0, stream, XB, 1024L, WQ, 1024L, 1024, 0L, 0L, 0L, 0L, EpiQC{BA});
    hipLaunchKernelGGL((ngemm<EpiS, false>), dim3(256 / 128, SEQ / 32, 16), dim3(256), 0, stream, BA, 1024L, KC, 1024L, 256, (long)SEQ * 1024, 256L, 256L * 1024, 256L, EpiS{TEMP});
    hipLaunchKernelGGL(nxsoftmax, dim3(M * 4 / 4), dim3(256), 0, stream, TEMP, Pb);
    hipLaunchKernelGGL((ngemm<EpiPV, false>), dim3(256 / 128, SEQ / 32, 16), dim3(256), 0, stream, Pb, 1024L, VCT, 256L, 256, (long)SEQ * 1024, 256L, 1024L * 256, 256L * 256, EpiPV{BA});
    hipLaunchKernelGGL((ngemm<EpiF32, false>), dim3(1024 / 128, M / 32, 1), dim3(256), 0, stream, BA, 1024L, WOM, 1024L, 1024, 0L, 0L, 0L, 0L, EpiF32{TEMP});
    hipLaunchKernelGGL((nln<1, true>), dim3(M / 4), dim3(256), 0, stream, TEMP, in[0], STATS, in[2], in[3], in[22], in[23], out, XB);
    hipLaunchKernelGGL((ngemm<EpiSwi, true>), dim3(DFF / 128, M / 32, 1), dim3(256), 0, stream, XB, 1024L, WGU, 1024L, 1024, 0L, 0L, 0L, 0L, EpiSwi{HDN});
    hipLaunchKernelGGL((ngemm<EpiF32, false>), dim3(1024 / 128, M / 32, 1), dim3(256), 0, stream, HDN, (long)DFF, WDN, (long)DFF, DFF, 0L, 0L, 0L, 0L, EpiF32{TEMP});
    hipLaunchKernelGGL((nln<1, false>), dim3(M / 4), dim3(256), 0, stream, TEMP, in[0], STATS, in[2], in[3], in[27], in[28], out, XB);
}
```
